# Optimizing an MI355X kernel written in HIP

```python
import math
import jax, jax.numpy as jnp
from jax import lax
import numpy as np

D_MODEL = 2048
BATCH = 2
SEQ = 4096
DEPTH = 1

GRID_W = 64
HEAD_DIM = 128
NA_HEADS = 8
NA_WIDTH = NA_HEADS * HEAD_DIM
NA_WIN_ROWS = 8
NA_WIN_COLS = 16
DIFF_HEADS = 4
DIFF_QK_DIM = HEAD_DIM
DIFF_V_DIM = 2 * HEAD_DIM
DIFF_QK_WIDTH = DIFF_HEADS * 2 * DIFF_QK_DIM
DIFF_WIDTH = DIFF_HEADS * DIFF_V_DIM
MIX_WIDTH = NA_WIDTH + DIFF_WIDTH
IN_WIDTH = 3 * NA_WIDTH + 2 * DIFF_QK_WIDTH + DIFF_WIDTH
D_FF = -(-8 * D_MODEL // (3 * 256)) * 256
REL_BUCKETS = 32
REL_MAX_DIST = 128
Q_BLOCK = 128
LN_EPS = 1e-5
DEEPNORM_ALPHA = (2.0 * DEPTH) ** 0.25
DEEPNORM_BETA = (8.0 * DEPTH) ** -0.25

kernel_name = "hybrid_natten_diffattn_deepnorm_encoder"


def layer_norm(x, g, b):
    xf = x.astype(jnp.float32)
    mu = jnp.mean(xf, axis=-1, keepdims=True)
    var = jnp.mean(jnp.square(xf - mu), axis=-1, keepdims=True)
    return ((xf - mu) * lax.rsqrt(var + LN_EPS) * g.astype(jnp.float32) + b.astype(jnp.float32)).astype(x.dtype)


def rms_norm(x, g):
    xf = x.astype(jnp.float32)
    return (xf * lax.rsqrt(jnp.mean(jnp.square(xf), axis=-1, keepdims=True) + LN_EPS) * g.astype(jnp.float32)).astype(x.dtype)


def t5_bucket(rel):
    nb = REL_BUCKETS // 2
    max_exact = nb // 2
    ret = (rel > 0).astype(jnp.int32) * nb
    n = jnp.abs(rel)
    nf = jnp.maximum(n, 1).astype(jnp.float32)
    large = max_exact + (jnp.log(nf / max_exact) / math.log(REL_MAX_DIST / max_exact) * (nb - max_exact)).astype(jnp.int32)
    large = jnp.minimum(large, nb - 1)
    return ret + jnp.where(n < max_exact, n, large)


def neighbourhood_attention(q, k, v, rpb):
    B, S, H, d = q.shape
    rows = S // GRID_W
    kh = min(NA_WIN_ROWS, rows)
    kw = NA_WIN_COLS
    qg = (q * (d ** -0.5)).reshape(B, rows, GRID_W, H, d)
    kg = k.reshape(B, rows, GRID_W, H, d)
    vg = v.reshape(B, rows, GRID_W, H, d)
    cols = jnp.arange(GRID_W)
    c_start = jnp.clip(cols - kw // 2, 0, GRID_W - kw)
    c_idx = c_start[:, None] + jnp.arange(kw)[None, :]
    dc = c_idx - cols[:, None] + (NA_WIN_COLS - 1)
    rpb_c = rpb[:, :, dc]

    def row_block(r):
        r_start = jnp.clip(r - kh // 2, 0, rows - kh)
        q_r = lax.dynamic_index_in_dim(qg, r, axis=1, keepdims=False)
        k_band = lax.dynamic_slice_in_dim(kg, r_start, kh, axis=1)
        v_band = lax.dynamic_slice_in_dim(vg, r_start, kh, axis=1)
        k_n = k_band[:, :, c_idx]
        v_n = v_band[:, :, c_idx]
        logits = jnp.einsum('bchd,brckhd->bhcrk', q_r, k_n).astype(jnp.float32)
        dr = r_start + jnp.arange(kh) - r + (NA_WIN_ROWS - 1)
        bias = jnp.transpose(rpb_c[:, dr], (0, 2, 1, 3)).astype(jnp.float32)
        logits = logits + bias[None]
        p = jax.nn.softmax(logits.reshape(B, H, GRID_W, kh * kw), axis=-1)
        p = p.reshape(B, H, GRID_W, kh, kw).astype(v.dtype)
        return jnp.einsum('bhcrk,brckhd->bchd', p, v_n)

    out = lax.map(row_block, jnp.arange(rows))
    return jnp.transpose(out, (1, 0, 2, 3, 4)).reshape(B, S, H * d)


def differential_attention(q, k, v, lam, rel_table):
    B, S, H, _, dq = q.shape
    dv = v.shape[-1]
    nblk = S // Q_BLOCK
    qb = jnp.transpose((q * (dq ** -0.5)).reshape(B, nblk, Q_BLOCK, H, 2, dq), (1, 0, 2, 3, 4, 5))
    k_pos = jnp.arange(S, dtype=jnp.int32)

    def q_block(args):
        q_i, i = args
        q_pos = i * Q_BLOCK + jnp.arange(Q_BLOCK, dtype=jnp.int32)
        bias = rel_table[t5_bucket(k_pos[None, :] - q_pos[:, None])]
        bias = jnp.transpose(bias, (2, 0, 1)).astype(jnp.float32)
        logits = jnp.einsum('bqhmd,bkhmd->bhmqk', q_i, k).astype(jnp.float32) + bias[None, :, None]
        p = jax.nn.softmax(logits, axis=-1)
        w = (p[:, :, 0] - lam * p[:, :, 1]).astype(v.dtype)
        return jnp.einsum('bhqk,bkhd->bqhd', w, v)

    out = lax.map(q_block, (qb, jnp.arange(nblk, dtype=jnp.int32)))
    return jnp.transpose(out, (1, 0, 2, 3, 4)).reshape(B, S, H, dv)


def setup_inputs(seed: int = 0) -> dict:
    key = jax.random.key(seed)
    ks = jax.random.split(key, 20)
    f32 = jnp.float32
    beta = DEEPNORM_BETA
    col_scale = np.ones((IN_WIDTH,), dtype=np.float32)
    col_scale[2 * NA_WIDTH:3 * NA_WIDTH] = beta
    col_scale[IN_WIDTH - DIFF_WIDTH:] = beta
    w_in = jax.random.normal(ks[1], (DEPTH, D_MODEL, IN_WIDTH), f32) * (D_MODEL ** -0.5) * jnp.asarray(col_scale)
    return {
        'x': jax.random.normal(ks[0], (BATCH, SEQ, D_MODEL), f32),
        'ln_in_g': 1.0 + 0.02 * jax.random.normal(ks[2], (D_MODEL,), f32),
        'ln_in_b': 0.02 * jax.random.normal(ks[3], (D_MODEL,), f32),
        'w_in': w_in,
        'na_rpb': 0.1 * jax.random.normal(ks[4], (DEPTH, NA_HEADS, 2 * NA_WIN_ROWS - 1, 2 * NA_WIN_COLS - 1), f32),
        'lambda_q1': 0.1 * jax.random.normal(ks[5], (DEPTH, DIFF_QK_DIM), f32),
        'lambda_k1': 0.1 * jax.random.normal(ks[6], (DEPTH, DIFF_QK_DIM), f32),
        'lambda_q2': 0.1 * jax.random.normal(ks[7], (DEPTH, DIFF_QK_DIM), f32),
        'lambda_k2': 0.1 * jax.random.normal(ks[8], (DEPTH, DIFF_QK_DIM), f32),
        'diff_subln_g': 1.0 + 0.02 * jax.random.normal(ks[9], (DEPTH, DIFF_V_DIM), f32),
        'rel_bias_table': 0.1 * jax.random.normal(ks[10], (REL_BUCKETS, DIFF_HEADS), f32),
        'w_out': jax.random.normal(ks[11], (DEPTH, MIX_WIDTH, D_MODEL), f32) * (MIX_WIDTH ** -0.5) * beta,
        'ln1_g': 1.0 + 0.02 * jax.random.normal(ks[12], (DEPTH, D_MODEL), f32),
        'ln1_b': 0.02 * jax.random.normal(ks[13], (DEPTH, D_MODEL), f32),
        'w_gate': jax.random.normal(ks[14], (DEPTH, D_MODEL, D_FF), f32) * (D_MODEL ** -0.5) * beta,
        'w_up': jax.random.normal(ks[15], (DEPTH, D_MODEL, D_FF), f32) * (D_MODEL ** -0.5) * beta,
        'w_down': jax.random.normal(ks[16], (DEPTH, D_FF, D_MODEL), f32) * (D_FF ** -0.5) * beta,
        'ln2_g': 1.0 + 0.02 * jax.random.normal(ks[17], (DEPTH, D_MODEL), f32),
        'ln2_b': 0.02 * jax.random.normal(ks[18], (DEPTH, D_MODEL), f32),
    }


def reference(x, ln_in_g, ln_in_b, w_in, na_rpb, lambda_q1, lambda_k1, lambda_q2, lambda_k2,
              diff_subln_g, rel_bias_table, w_out, ln1_g, ln1_b, w_gate, w_up, w_down, ln2_g, ln2_b):
    B, S, _ = x.shape
    splits = [NA_WIDTH, 2 * NA_WIDTH, 3 * NA_WIDTH, 3 * NA_WIDTH + DIFF_QK_WIDTH, 3 * NA_WIDTH + 2 * DIFF_QK_WIDTH]
    h = layer_norm(x, ln_in_g, ln_in_b)
    for l in range(DEPTH):
        proj = jnp.einsum('bsd,de->bse', h, w_in[l])
        na_q, na_k, na_v, d_q, d_k, d_v = jnp.split(proj, splits, axis=-1)
        na_out = neighbourhood_attention(na_q.reshape(B, S, NA_HEADS, HEAD_DIM),
                                         na_k.reshape(B, S, NA_HEADS, HEAD_DIM),
                                         na_v.reshape(B, S, NA_HEADS, HEAD_DIM), na_rpb[l])
        lambda_init = 0.8 - 0.6 * math.exp(-0.3 * l)
        lam = (jnp.exp(jnp.sum(lambda_q1[l].astype(jnp.float32) * lambda_k1[l].astype(jnp.float32)))
               - jnp.exp(jnp.sum(lambda_q2[l].astype(jnp.float32) * lambda_k2[l].astype(jnp.float32)))
               + lambda_init)
        diff_out = differential_attention(d_q.reshape(B, S, DIFF_HEADS, 2, DIFF_QK_DIM),
                                          d_k.reshape(B, S, DIFF_HEADS, 2, DIFF_QK_DIM),
                                          d_v.reshape(B, S, DIFF_HEADS, DIFF_V_DIM), lam, rel_bias_table)
        diff_out = (rms_norm(diff_out, diff_subln_g[l]) * (1.0 - lambda_init)).reshape(B, S, DIFF_WIDTH)
        mixed = jnp.einsum('bse,ed->bsd', jnp.concatenate([na_out, diff_out], axis=-1), w_out[l])
        h = layer_norm(DEEPNORM_ALPHA * h + mixed, ln1_g[l], ln1_b[l])
        ffn = jnp.einsum('bsf,fd->bsd', jax.nn.silu(jnp.einsum('bsd,df->bsf', h, w_gate[l]))
                         * jnp.einsum('bsd,df->bsf', h, w_up[l]), w_down[l])
        h = layer_norm(DEEPNORM_ALPHA * h + ffn, ln2_g[l], ln2_b[l])
    return h
```

```cpp
#include <hip/hip_runtime.h>
#include <cstdio>
#include <cstdint>

namespace cfg {
constexpr int DM = 2048, BATCH = 2, SEQ = 4096, M = BATCH * SEQ;
constexpr int GW = 64, HD = 128, NAH = 8, NAW = 1024, DH = 4, DQK = 128, DV = 256;
constexpr int INW = 6144, DFF = 5632;
constexpr float LN_EPS = 1e-5f;
constexpr float ALPHA = 1.189207115002721f;
constexpr float LAMBDA_INIT = 0.2f;
constexpr float QSCALE = 0.08838834764831845f;
}
using namespace cfg;

__device__ __forceinline__ float block_sum_256(float v, float* red) {
    for (int o = 32; o > 0; o >>= 1) v += __shfl_xor(v, o);
    __syncthreads();
    if ((threadIdx.x & 63) == 0) red[threadIdx.x >> 6] = v;
    __syncthreads();
    float r = red[0] + red[1] + red[2] + red[3];
    return r;
}
__device__ __forceinline__ float block_max_256(float v, float* red) {
    for (int o = 32; o > 0; o >>= 1) v = fmaxf(v, __shfl_xor(v, o));
    __syncthreads();
    if ((threadIdx.x & 63) == 0) red[threadIdx.x >> 6] = v;
    __syncthreads();
    return fmaxf(fmaxf(red[0], red[1]), fmaxf(red[2], red[3]));
}

__global__ __launch_bounds__(256) void ln_rows(const float* in, const float* __restrict__ g, const float* __restrict__ b, float* out) {
    __shared__ float red[4];
    const size_t row = blockIdx.x; const int t = threadIdx.x;
    float v[8]; float s = 0.f;
    for (int i = 0; i < 8; ++i) { v[i] = in[row * DM + t + 256 * i]; s += v[i]; }
    const float mean = block_sum_256(s, red) * (1.f / DM);
    float q = 0.f;
    for (int i = 0; i < 8; ++i) { v[i] -= mean; q += v[i] * v[i]; }
    const float var = block_sum_256(q, red) * (1.f / DM);
    const float rstd = 1.0f / sqrtf(var + LN_EPS);
    for (int i = 0; i < 8; ++i) { const int c = t + 256 * i; out[row * DM + c] = v[i] * rstd * g[c] + b[c]; }
}

template <int EPI>
__global__ __launch_bounds__(256) void gemm_naive(const float* __restrict__ A, const float* __restrict__ B, const float* __restrict__ B2,
                                                  const float* R, float* C, int Mm, int N, int K) {
    __shared__ float As[8][128 + 4];
    __shared__ float Bs[8][128 + 4];
    __shared__ float Bs2[EPI == 2 ? 8 : 1][128 + 4];
    const int t = threadIdx.x, tx = t & 15, ty = t >> 4;
    const int row0 = blockIdx.y * 128, col0 = blockIdx.x * 128;
    float acc[8][8] = {}; float acc2[EPI == 2 ? 8 : 1][8] = {};
    for (int k0 = 0; k0 < K; k0 += 8) {
        { const int r = t >> 1, kk = (t & 1) * 4; const float4 a = *(const float4*)(A + (size_t)(row0 + r) * K + k0 + kk);
          As[kk + 0][r] = a.x; As[kk + 1][r] = a.y; As[kk + 2][r] = a.z; As[kk + 3][r] = a.w; }
        { const int kk = t >> 5, c = (t & 31) * 4; const float4 b = *(const float4*)(B + (size_t)(k0 + kk) * N + col0 + c);
          *(float4*)&Bs[kk][c] = b;
          if (EPI == 2) { const float4 b2 = *(const float4*)(B2 + (size_t)(k0 + kk) * N + col0 + c); *(float4*)&Bs2[kk][c] = b2; } }
        __syncthreads();
#pragma unroll
        for (int kk = 0; kk < 8; ++kk) {
            float a[8], b[8];
            *(float4*)&a[0] = *(const float4*)&As[kk][ty * 8]; *(float4*)&a[4] = *(const float4*)&As[kk][ty * 8 + 4];
            *(float4*)&b[0] = *(const float4*)&Bs[kk][tx * 8]; *(float4*)&b[4] = *(const float4*)&Bs[kk][tx * 8 + 4];
#pragma unroll
            for (int i = 0; i < 8; ++i)
#pragma unroll
                for (int j = 0; j < 8; ++j) acc[i][j] = fmaf(a[i], b[j], acc[i][j]);
            if (EPI == 2) {
                float b2[8];
                *(float4*)&b2[0] = *(const float4*)&Bs2[kk][tx * 8]; *(float4*)&b2[4] = *(const float4*)&Bs2[kk][tx * 8 + 4];
#pragma unroll
                for (int i = 0; i < 8; ++i)
#pragma unroll
                    for (int j = 0; j < 8; ++j) acc2[i][j] = fmaf(a[i], b2[j], acc2[i][j]);
            }
        }
        __syncthreads();
    }
    for (int i = 0; i < 8; ++i)
        for (int j = 0; j < 8; ++j) {
            const size_t o = (size_t)(row0 + ty * 8 + i) * N + col0 + tx * 8 + j;
            float v = acc[i][j];
            if (EPI == 1) v = ALPHA * R[o] + v;
            if (EPI == 2) { const float gte = v; v = gte / (1.f + __expf(-gte)) * acc2[i][j]; }
            C[o] = v;
        }
}

__global__ __launch_bounds__(128) void na_naive(const float* __restrict__ P, const float* __restrict__ rpb, float* MIX) {
    __shared__ float qs[128]; __shared__ float ps[128]; __shared__ float red[2];
    const int tok = blockIdx.x, h = blockIdx.y, t = threadIdx.x;
    const int b = tok / SEQ, s = tok % SEQ, r = s / GW, c = s % GW;
    const int rs = min(max(r - 4, 0), 64 - 8), cs = min(max(c - 8, 0), GW - 16);
    qs[t] = P[(size_t)tok * INW + h * HD + t] * QSCALE;
    __syncthreads();
    const int i = t >> 4, j = t & 15;
    const int ktok = b * SEQ + (rs + i) * GW + cs + j;
    const float* kp = P + (size_t)ktok * INW + NAW + h * HD;
    float sc = 0.f;
    for (int d = 0; d < HD; ++d) sc = fmaf(qs[d], kp[d], sc);
    sc += rpb[(h * 15 + (rs + i - r + 7)) * 31 + (cs + j - c + 15)];
    float mx = sc;
    for (int o = 32; o > 0; o >>= 1) mx = fmaxf(mx, __shfl_xor(mx, o));
    if ((t & 63) == 0) red[t >> 6] = mx;
    __syncthreads();
    mx = fmaxf(red[0], red[1]);
    const float e = __expf(sc - mx);
    float sm = e;
    for (int o = 32; o > 0; o >>= 1) sm += __shfl_xor(sm, o);
    __syncthreads();
    if ((t & 63) == 0) red[t >> 6] = sm;
    __syncthreads();
    sm = red[0] + red[1];
    ps[t] = e / sm;
    __syncthreads();
    float o = 0.f;
    for (int k = 0; k < 128; ++k) {
        const int kt = b * SEQ + (rs + (k >> 4)) * GW + cs + (k & 15);
        o = fmaf(ps[k], P[(size_t)kt * INW + 2 * NAW + h * HD + t], o);
    }
    MIX[(size_t)tok * DM + h * HD + t] = o;
}

__device__ __forceinline__ int t5_bucket(int rel) {
    const int n = rel < 0 ? -rel : rel;
    int bkt;
    if (n < 8) bkt = n;
    else { int large = 2 + (31 - __clz(n * n)); bkt = large < 15 ? large : 15; }
    return bkt + (rel > 0 ? 16 : 0);
}

__global__ __launch_bounds__(256) void diff_naive(const float* __restrict__ P, const float* __restrict__ lq1, const float* __restrict__ lk1,
                                                  const float* __restrict__ lq2, const float* __restrict__ lk2, const float* __restrict__ subg,
                                                  const float* __restrict__ relt, float* MIX) {
    __shared__ float sc[2][SEQ]; __shared__ float qs[2][128]; __shared__ float red[4];
    const int tok = blockIdx.x, h = blockIdx.y, t = threadIdx.x, lane = t & 63, w = t >> 6;
    const int b = tok / SEQ, s = tok % SEQ;
    qs[t >> 7][t & 127] = P[(size_t)tok * INW + 3 * NAW + h * 256 + t] * QSCALE;
    float l1 = (t < 128) ? lq1[t] * lk1[t] : 0.f, l2 = (t < 128) ? lq2[t] * lk2[t] : 0.f;
    l1 = block_sum_256(l1, red); l2 = block_sum_256(l2, red);
    const float lam = __expf(l1) - __expf(l2) + LAMBDA_INIT;
    __syncthreads();
    for (int m = 0; m < 2; ++m) {
        const float q0 = qs[m][2 * lane], q1 = qs[m][2 * lane + 1];
        for (int k = w; k < SEQ; k += 4) {
            const float2 kv = *(const float2*)(P + (size_t)(b * SEQ + k) * INW + 4 * NAW + h * 256 + m * 128 + 2 * lane);
            float d = q0 * kv.x + q1 * kv.y;
            for (int o = 32; o > 0; o >>= 1) d += __shfl_xor(d, o);
            if (lane == 0) sc[m][k] = d + relt[t5_bucket(k - s) * DH + h];
        }
    }
    __syncthreads();
    float mx[2], sm[2];
    for (int m = 0; m < 2; ++m) {
        float a = -1e30f;
        for (int k = t; k < SEQ; k += 256) a = fmaxf(a, sc[m][k]);
        mx[m] = block_max_256(a, red);
        float z = 0.f;
        for (int k = t; k < SEQ; k += 256) { const float e = __expf(sc[m][k] - mx[m]); sc[m][k] = e; z += e; }
        sm[m] = block_sum_256(z, red);
    }
    __syncthreads();
    for (int k = t; k < SEQ; k += 256) sc[0][k] = sc[0][k] / sm[0] - lam * (sc[1][k] / sm[1]);
    __syncthreads();
    float o = 0.f;
    for (int k = 0; k < SEQ; ++k) o = fmaf(sc[0][k], P[(size_t)(b * SEQ + k) * INW + 5 * NAW + h * 256 + t], o);
    const float ms = block_sum_256(o * o, red) * (1.f / 256.f);
    MIX[(size_t)tok * DM + NAW + h * 256 + t] = o * (1.0f / sqrtf(ms + LN_EPS)) * subg[t] * (1.f - LAMBDA_INIT);
}

extern "C" void kernel_launch(void* const* d_in, const int* in_sizes, int n_in, void* d_out, int out_size, void* d_ws, size_t ws_size, hipStream_t stream) {
    const float* x = (const float*)d_in[0]; const float* ln_in_g = (const float*)d_in[1]; const float* ln_in_b = (const float*)d_in[2];
    const float* w_in = (const float*)d_in[3]; const float* na_rpb = (const float*)d_in[4];
    const float* lq1 = (const float*)d_in[5]; const float* lk1 = (const float*)d_in[6]; const float* lq2 = (const float*)d_in[7]; const float* lk2 = (const float*)d_in[8];
    const float* subg = (const float*)d_in[9]; const float* relt = (const float*)d_in[10]; const float* w_out = (const float*)d_in[11];
    const float* ln1_g = (const float*)d_in[12]; const float* ln1_b = (const float*)d_in[13];
    const float* w_gate = (const float*)d_in[14]; const float* w_up = (const float*)d_in[15]; const float* w_down = (const float*)d_in[16];
    const float* ln2_g = (const float*)d_in[17]; const float* ln2_b = (const float*)d_in[18];
    float* out = (float*)d_out;
    float* PROJ = (float*)d_ws;
    float* MIX = (float*)((char*)d_ws + (size_t)M * INW * 4);
    if (ws_size < (size_t)M * INW * 4 + (size_t)M * DM * 4) { fprintf(stderr, "ws too small: %zu\n", ws_size); return; }
    ln_rows<<<M, 256, 0, stream>>>(x, ln_in_g, ln_in_b, out);
    gemm_naive<0><<<dim3(INW / 128, M / 128), 256, 0, stream>>>(out, w_in, nullptr, nullptr, PROJ, M, INW, DM);
    na_naive<<<dim3(M, NAH), 128, 0, stream>>>(PROJ, na_rpb, MIX);
    diff_naive<<<dim3(M, DH), 256, 0, stream>>>(PROJ, lq1, lk1, lq2, lk2, subg, relt, MIX);
    gemm_naive<1><<<dim3(DM / 128, M / 128), 256, 0, stream>>>(MIX, w_out, nullptr, out, out, M, DM, DM);
    ln_rows<<<M, 256, 0, stream>>>(out, ln1_g, ln1_b, out);
    float* HMID = PROJ;
    gemm_naive<2><<<dim3(DFF / 128, M / 128), 256, 0, stream>>>(out, w_gate, w_up, nullptr, HMID, M, DFF, DM);
    gemm_naive<1><<<dim3(DM / 128, M / 128), 256, 0, stream>>>(HMID, w_down, nullptr, out, out, M, DM, DFF);
    ln_rows<<<M, 256, 0, stream>>>(out, ln2_g, ln2_b, out);
}
```

```cpp
#include <hip/hip_runtime.h>
#include <cstdio>
#include <cstdint>

#ifndef HYB
#define HYB 0
#endif

namespace cfg {
constexpr int DM = 2048, BATCH = 2, SEQ = 4096, M = BATCH * SEQ;
constexpr int GW = 64, HD = 128, NAH = 8, NAW = 1024, DH = 4, DQK = 128, DV = 256;
constexpr int INW = 6144, DFF = 5632, NGU = 2 * DFF;
constexpr float LN_EPS = 1e-5f;
constexpr float ALPHA = 1.189207115002721f;
constexpr float LAMBDA_INIT = 0.2f;
constexpr float QSCALE = 0.08838834764831845f;
constexpr float LOG2E = 1.4426950408889634f, LN2 = 0.6931471805599453f;
constexpr float QS2 = QSCALE * LOG2E;
}
using namespace cfg;

namespace pg8 {
#define PG8_LAS __attribute__((address_space(3)))
typedef unsigned short bf16_t;
typedef short bf16x8 __attribute__((ext_vector_type(8)));
typedef float f32x4 __attribute__((ext_vector_type(4)));
typedef unsigned u32x4 __attribute__((ext_vector_type(4)));
constexpr int BM = 256, BK = 64, HALF = 128, HTB = HALF * BK * 2  , STAGE_BYTES = 8 * HTB, NXCD = 8, WGM = 8;

__host__ __device__ __forceinline__ int lds_byte(int r, int c) { const int st = (r >> 4) * 2 + (c >> 5), rr = r & 15, cc = c & 31, ob = rr * 64 + cc * 2; return st * 1024 + (ob ^ (((ob >> 9) & 1) << 5)); }
__host__ __device__ __forceinline__ void stage_rc(int b, int& R, int& C) { const int st = b / 1024, sb = b % 1024, swz = sb ^ (((sb >> 9) & 1) << 5); R = (st >> 1) * 16 + swz / 64; C = (st & 1) * 32 + (swz % 64) / 2; }
__host__ __device__ __forceinline__ int perm32(int rho) { const int n = rho >> 4, i = rho & 15; return 8 * (i >> 2) + 4 * n + (i & 3); }

struct Unit { int pm, pn; };
struct Gemm { const bf16_t* A; const bf16_t* Bt; int M, N, K; };

struct StaticOrder {
    int nM, nN, nwg, G, c;
    __host__ __device__ void init(int M, int N, int G_, int c_) { nM = M / BM; nN = N / BM; nwg = nM * nN; G = G_; c = c_; }
    __host__ __device__ bool next(int i, Unit& u) const {
        const long L = (long)i * G + c; if (L >= nwg) return false;
        int wgid = (int)L; { const int q = nwg / NXCD, r = nwg % NXCD, xcd = wgid % NXCD, off = wgid / NXCD; wgid = (xcd < r ? xcd * (q + 1) : r * (q + 1) + (xcd - r) * q) + off; }
        const int nig = WGM * nN, gid = wgid / nig, fm = gid * WGM, gsz = (nM - fm) < WGM ? (nM - fm) : WGM;
        u.pm = fm + ((wgid % nig) % gsz); u.pn = (wgid % nig) / gsz; return true;
    }
    __device__ __forceinline__ void a_ready(const Unit&) const {}
    __device__ __forceinline__ void done(const Unit&) const {}
};

__device__ __forceinline__ unsigned cvt_pk_bf16(float lo, float hi) { unsigned r; asm volatile("v_cvt_pk_bf16_f32 %0, %1, %2" : "=v"(r) : "v"(lo), "v"(hi)); return r; }

struct EpiProj {
    static constexpr bool PERM = true, AFTER_DRAIN = false;
    bf16_t* O; int ldc;
    __device__ __forceinline__ void operator()(const f32x4 (&acc)[2][2][4][2], const Unit& u, int wr, int wc, int fr, int fq) const {
        const int row0 = u.pm * BM + wr * 64 + fr; const int col0 = u.pn * BM + wc * 32 + 8 * fq;
        const float sc = (u.pn < 4 || (u.pn >= 12 && u.pn < 16)) ? QS2 : 1.0f;
#pragma unroll
        for (int ai = 0; ai < 2; ++ai)
#pragma unroll
            for (int m = 0; m < 4; ++m) { bf16_t* rowp = O + (size_t)(row0 + ai * HALF + m * 16) * ldc + col0;
#pragma unroll
                for (int bj = 0; bj < 2; ++bj) { const f32x4 v0 = acc[ai][bj][m][0] * sc, v1 = acc[ai][bj][m][1] * sc;
                    u32x4 w; w.x = cvt_pk_bf16(v0[0], v0[1]); w.y = cvt_pk_bf16(v0[2], v0[3]); w.z = cvt_pk_bf16(v1[0], v1[1]); w.w = cvt_pk_bf16(v1[2], v1[3]);
                    *(u32x4*)(rowp + bj * HALF) = w; } }
    }
};
__device__ __forceinline__ float silu_mul(float g, float u) { return g * __builtin_amdgcn_rcpf(1.0f + __builtin_amdgcn_exp2f(-g * LOG2E)) * u; }
struct EpiSwiGLU {
    static constexpr bool PERM = true, AFTER_DRAIN = false;
    bf16_t* O; int ldc;
    __device__ __forceinline__ void operator()(const f32x4 (&acc)[2][2][4][2], const Unit& u, int wr, int wc, int fr, int fq) const {
        const int row0 = u.pm * BM + wr * 64 + fr; const int col0 = u.pn * HALF + wc * 32 + 8 * fq;
#pragma unroll
        for (int ai = 0; ai < 2; ++ai)
#pragma unroll
            for (int m = 0; m < 4; ++m) { bf16_t* rowp = O + (size_t)(row0 + ai * HALF + m * 16) * ldc + col0;
                const f32x4 g0 = acc[ai][0][m][0], g1 = acc[ai][0][m][1], u0 = acc[ai][1][m][0], u1 = acc[ai][1][m][1];
                u32x4 w; w.x = cvt_pk_bf16(silu_mul(g0[0], u0[0]), silu_mul(g0[1], u0[1])); w.y = cvt_pk_bf16(silu_mul(g0[2], u0[2]), silu_mul(g0[3], u0[3]));
                w.z = cvt_pk_bf16(silu_mul(g1[0], u1[0]), silu_mul(g1[1], u1[1])); w.w = cvt_pk_bf16(silu_mul(g1[2], u1[2]), silu_mul(g1[3], u1[3]));
                *(u32x4*)rowp = w; }
    }
};
struct EpiRes {
    static constexpr bool PERM = false, AFTER_DRAIN = false;
    float* out; int ldc;
    __device__ __forceinline__ void operator()(const f32x4 (&acc)[2][2][4][2], const Unit& u, int wr, int wc, int fr, int fq) const {
        const int col0 = u.pn * BM + wc * 32 + 4 * fq;
#pragma unroll
        for (int ai = 0; ai < 2; ++ai)
#pragma unroll
            for (int m = 0; m < 4; ++m) { const size_t off = (size_t)(u.pm * BM + ai * HALF + wr * 64 + m * 16 + fr) * ldc + col0;
#pragma unroll
                for (int bj = 0; bj < 2; ++bj)
#pragma unroll
                    for (int n = 0; n < 2; ++n) { float* p = out + off + bj * HALF + n * 16; const f32x4 bs = *(const f32x4*)p; *(f32x4*)p = bs * ALPHA + acc[ai][bj][m][n]; } }
    }
};

template <class Epi, class Sched, bool ALIGN_EPI = false, bool SP2 = false>
__device__ __forceinline__ void gemm_phase(PG8_LAS unsigned char* lds, const Gemm g, const Sched& S, const Epi& E) {
    const int tid = threadIdx.x, wid = __builtin_amdgcn_readfirstlane(tid >> 6), lane = tid & 63, wr = wid >> 2, wc = wid & 3, fr = lane & 15, fq = lane >> 4;
    const int K = g.K, nt = K / BK;
    unsigned voffA[2], voffB[2];
#pragma unroll
    for (int i = 0; i < 2; ++i) { int R, C; stage_rc(tid * 16 + i * 8192, R, C); const int Rb = Epi::PERM ? ((R & ~31) + perm32(R & 31)) : R;
        voffA[i] = (unsigned)(R * K + C) * 2u; voffB[i] = (unsigned)(Rb * K + C) * 2u; }
    const size_t kstep = (size_t)(BK * 2);
    const size_t hstep = (size_t)HALF * K * 2;
    const size_t tstep = 2 * hstep;
    const unsigned ldsw = (unsigned)wid * 1024u;
    const int aoff = lds_byte(wr * 64 + fr, fq * 8), boff = lds_byte(wc * 32 + fr, fq * 8);
#define PG8_SA(b, h) (((b) * 2 + (h)) * HTB)
#define PG8_SB(b, h) ((4 + (b) * 2 + (h)) * HTB)
#define PG8_STAGE(bufoff, gbase, voff) do { _Pragma("unroll") for (int _i = 0; _i < 2; ++_i) \
        __builtin_amdgcn_global_load_lds((const unsigned*)((const char*)(gbase) + (voff)[_i]), (PG8_LAS unsigned*)(lds + (bufoff) + ldsw + _i * 8192), 16, 0, 0); } while (0)
#define PG8_LDA(dst, b, h) do { _Pragma("unroll") for (int m = 0; m < 4; ++m) _Pragma("unroll") for (int k = 0; k < 2; ++k) dst[m][k] = *(const PG8_LAS bf16x8*)(lds + PG8_SA(b, h) + aoff + m * 2048 + k * 1024); } while (0)
#define PG8_LDB(dst, b, h) do { _Pragma("unroll") for (int n = 0; n < 2; ++n) _Pragma("unroll") for (int k = 0; k < 2; ++k) dst[n][k] = *(const PG8_LAS bf16x8*)(lds + PG8_SB(b, h) + boff + n * 2048 + k * 1024); } while (0)
#define PG8_MMA(ai, bj, At, Bt) do { __builtin_amdgcn_s_setprio(1); _Pragma("unroll") for (int m = 0; m < 4; ++m) _Pragma("unroll") for (int n = 0; n < 2; ++n) _Pragma("unroll") for (int k = 0; k < 2; ++k) \
        acc[ai][bj][m][n] = __builtin_amdgcn_mfma_f32_16x16x32_bf16(Bt[n][k], At[m][k], acc[ai][bj][m][n], 0, 0, 0); __builtin_amdgcn_s_setprio(0); } while (0)
#define PG8_WAIT_V(n) asm volatile("s_waitcnt vmcnt(" #n ")" ::: "memory")
#define PG8_WAIT_L(n) asm volatile("s_waitcnt lgkmcnt(" #n ")" ::: "memory")
#define PG8_BAR __builtin_amdgcn_s_barrier()
#define PG8_SCHED __builtin_amdgcn_sched_barrier(0)
    Unit cur, nxt; int ui = 0;
    if (!S.next(0, cur)) return;
    f32x4 acc[2][2][4][2];
#pragma unroll
    for (int a = 0; a < 2; ++a)
#pragma unroll
        for (int b = 0; b < 2; ++b)
#pragma unroll
            for (int m = 0; m < 4; ++m)
#pragma unroll
                for (int n = 0; n < 2; ++n) acc[a][b][m][n] = (f32x4){0.f, 0.f, 0.f, 0.f};
    bf16x8 At[4][2], B0[2][2], B1[2][2];
    const char* cA = (const char*)g.A + (size_t)cur.pm * tstep; const char* cB = (const char*)g.Bt + (size_t)cur.pn * tstep;
    S.a_ready(cur);
    if constexpr (SP2) {
        PG8_STAGE(PG8_SB(0, 0), cB, voffB); PG8_STAGE(PG8_SB(0, 1), cB + hstep, voffB); PG8_STAGE(PG8_SA(0, 0), cA, voffA); PG8_STAGE(PG8_SA(0, 1), cA + hstep, voffA);
        if (wr == 1) PG8_BAR;
        PG8_WAIT_V(2); PG8_BAR;
        PG8_STAGE(PG8_SB(1, 0), cB + kstep, voffB); PG8_STAGE(PG8_SA(1, 0), cA + kstep, voffA); PG8_STAGE(PG8_SB(1, 1), cB + hstep + kstep, voffB);
        PG8_WAIT_V(6); PG8_BAR;
    } else {
        PG8_STAGE(PG8_SB(0, 0), cB, voffB); PG8_STAGE(PG8_SA(0, 0), cA, voffA); PG8_STAGE(PG8_SB(0, 1), cB + hstep, voffB); PG8_STAGE(PG8_SA(0, 1), cA + hstep, voffA);
        if (wr == 1) PG8_BAR;
        PG8_WAIT_V(4); PG8_BAR;
        PG8_STAGE(PG8_SB(1, 0), cB + kstep, voffB); PG8_STAGE(PG8_SA(1, 0), cA + kstep, voffA); PG8_STAGE(PG8_SB(1, 1), cB + hstep + kstep, voffB);
        PG8_WAIT_V(6); PG8_BAR;
    }
    for (;;) {
        const bool has_next = S.next(ui + 1, nxt);
        const char* nA = has_next ? (const char*)g.A + (size_t)nxt.pm * tstep : cA; const char* nB = has_next ? (const char*)g.Bt + (size_t)nxt.pn * tstep : cB;
        for (int t = 0; t < nt; t += 2) {
            const bool last = (t == nt - 2);
            const char* a1 = cA + (size_t)(t + 1) * kstep;
            const char* a2 = last ? nA : cA + (size_t)(t + 2) * kstep; const char* b2 = last ? nB : cB + (size_t)(t + 2) * kstep;
            const char* a3 = a2 + kstep; const char* b3 = b2 + kstep;
            if (last && has_next) S.a_ready(nxt);
            if constexpr (SP2) {
            PG8_LDB(B0, 0, 0); PG8_LDB(B1, 0, 1); PG8_SCHED; PG8_LDA(At, 0, 0); PG8_STAGE(PG8_SA(1, 1), a1 + hstep, voffA);
            PG8_WAIT_V(8); PG8_WAIT_L(0); PG8_BAR; PG8_MMA(0, 0, At, B0); PG8_MMA(0, 1, At, B1); PG8_BAR; PG8_SCHED;
            PG8_LDA(At, 0, 1); PG8_STAGE(PG8_SB(0, 0), b2, voffB); PG8_STAGE(PG8_SB(0, 1), b2 + hstep, voffB); PG8_STAGE(PG8_SA(0, 0), a2, voffA);
            PG8_WAIT_V(8); PG8_WAIT_L(0); PG8_BAR; PG8_MMA(1, 0, At, B0); PG8_MMA(1, 1, At, B1); PG8_BAR; PG8_SCHED;
            PG8_LDB(B0, 1, 0); PG8_LDB(B1, 1, 1); PG8_SCHED; PG8_LDA(At, 1, 0); PG8_STAGE(PG8_SA(0, 1), a2 + hstep, voffA);
            PG8_WAIT_V(8); PG8_WAIT_L(0); PG8_BAR; PG8_MMA(0, 0, At, B0); PG8_MMA(0, 1, At, B1); PG8_BAR; PG8_SCHED;
            PG8_LDA(At, 1, 1); PG8_STAGE(PG8_SB(1, 0), b3, voffB); PG8_STAGE(PG8_SB(1, 1), b3 + hstep, voffB); PG8_STAGE(PG8_SA(1, 0), a3, voffA);
            PG8_WAIT_V(8); PG8_WAIT_L(0); PG8_BAR; PG8_MMA(1, 0, At, B0); PG8_MMA(1, 1, At, B1); PG8_BAR; PG8_SCHED;
            } else {
            PG8_LDB(B0, 0, 0); PG8_SCHED; PG8_LDA(At, 0, 0); PG8_STAGE(PG8_SA(1, 1), a1 + hstep, voffA);
            PG8_WAIT_L(8); PG8_BAR; PG8_WAIT_L(0); PG8_MMA(0, 0, At, B0); PG8_BAR; PG8_SCHED;
            PG8_LDB(B1, 0, 1); PG8_STAGE(PG8_SB(0, 0), b2, voffB);
            PG8_BAR; PG8_WAIT_L(0); PG8_MMA(0, 1, At, B1); PG8_BAR;
            PG8_LDA(At, 0, 1); PG8_STAGE(PG8_SA(0, 0), a2, voffA);
            PG8_BAR; PG8_WAIT_L(0); PG8_MMA(1, 0, At, B0); PG8_BAR; PG8_SCHED;
            PG8_STAGE(PG8_SB(0, 1), b2 + hstep, voffB);
            PG8_WAIT_V(6); PG8_BAR; PG8_MMA(1, 1, At, B1); PG8_BAR;
            PG8_LDB(B0, 1, 0); PG8_SCHED; PG8_LDA(At, 1, 0); PG8_STAGE(PG8_SA(0, 1), a2 + hstep, voffA);
            PG8_WAIT_L(8); PG8_BAR; PG8_WAIT_L(0); PG8_MMA(0, 0, At, B0); PG8_BAR; PG8_SCHED;
            PG8_LDB(B1, 1, 1); PG8_STAGE(PG8_SB(1, 0), b3, voffB);
            PG8_BAR; PG8_WAIT_L(0); PG8_MMA(0, 1, At, B1); PG8_BAR;
            PG8_LDA(At, 1, 1); PG8_STAGE(PG8_SA(1, 0), a3, voffA);
            PG8_BAR; PG8_WAIT_L(0); PG8_MMA(1, 0, At, B0); PG8_BAR; PG8_SCHED;
            PG8_STAGE(PG8_SB(1, 1), b3 + hstep, voffB);
            PG8_WAIT_V(6); PG8_BAR; PG8_MMA(1, 1, At, B1); PG8_BAR;
            }
        }
        if constexpr (ALIGN_EPI) { if (wr == 0) PG8_BAR; }
        if constexpr (!Epi::AFTER_DRAIN) { E(acc, cur, wr, wc, fr, fq); S.done(cur); }
        if (!has_next) break;
#pragma unroll
        for (int a = 0; a < 2; ++a)
#pragma unroll
            for (int b = 0; b < 2; ++b)
#pragma unroll
                for (int m = 0; m < 4; ++m)
#pragma unroll
                    for (int n = 0; n < 2; ++n) acc[a][b][m][n] = (f32x4){0.f, 0.f, 0.f, 0.f};
        cur = nxt; cA = nA; cB = nB; ++ui;
        if constexpr (ALIGN_EPI) { if (wr == 1) PG8_BAR; }
    }
    PG8_WAIT_V(0);
    if constexpr (!ALIGN_EPI) { if (wr == 0) PG8_BAR; }
    PG8_BAR;
    if constexpr (Epi::AFTER_DRAIN) { E.fused(acc, cur, wr, wc, fr, fq, lds, wid, lane); S.done(cur); }
#undef PG8_SA
#undef PG8_SB
#undef PG8_STAGE
#undef PG8_LDA
#undef PG8_LDB
#undef PG8_MMA
#undef PG8_WAIT_V
#undef PG8_WAIT_L
#undef PG8_BAR
#undef PG8_SCHED
}
}
namespace att {
typedef unsigned short bf16_t;
using bf16x8 = __attribute__((ext_vector_type(8))) short;
using s16x4  = __attribute__((ext_vector_type(4))) short;
using f32x16 = __attribute__((ext_vector_type(16))) float;
using u32x4  = __attribute__((ext_vector_type(4))) unsigned;
#define ATT_LAS __attribute__((address_space(3)))
constexpr int D = 128, NW = 8, QBLK = 32, KVBLK = 64, LDP = INW;
constexpr int SHM_V = KVBLK * D * 2, SHM_K = KVBLK * D * 2;
constexpr int OFF_V = 0, OFF_K = 2 * SHM_V, OFF_WS = 2 * SHM_V + 2 * SHM_K, OFF_T5 = OFF_WS + NW * 64 * 4, T5N = 384, OFF_NAT = OFF_T5 + T5N * 4, NAT_ROW = 128, LDS_END = OFF_NAT + 15 * NAT_ROW * 4;
#ifndef ATT_SDEPTH
#define ATT_SDEPTH 1
#endif
constexpr int SDEPTH = ATT_SDEPTH;
constexpr float THR_L2 = 8.0f * LOG2E;
#define KSWZ(row, colB) ((row) * 256 + ((colB) ^ (((row) & 7) << 4)))
#define SBAR() __builtin_amdgcn_sched_barrier(0)
__device__ __forceinline__ int crow(int r, int hi) { return (r & 3) + 8 * (r >> 2) + 4 * hi; }
__device__ __forceinline__ constexpr int krow(int r) { return (r & 3) + 8 * (r >> 2); }
__device__ __forceinline__ unsigned cvtpk(float lo, float hi) { unsigned r; asm volatile("v_cvt_pk_bf16_f32 %0, %1, %2" : "=v"(r) : "v"(lo), "v"(hi)); return r; }

__device__ __forceinline__ int t5_bucket(int rel) {
    const int n = rel < 0 ? -rel : rel;
    int bkt;
    if (n < 8) bkt = n;
    else { const int large = 2 + (31 - __clz(n * n)); bkt = large < 15 ? large : 15; }
    return bkt + (rel > 0 ? 16 : 0);
}

template <int MODE> struct TCtx {
    int qw;
    int tb;
    float cneg, cpos;
    int r_w, rs_w, a;
};
template <int MODE> __device__ __forceinline__ float tile_cinit(const TCtx<MODE>& c, int kt) {
    if constexpr (MODE == 0) { const int k0 = kt * KVBLK; return (k0 + 63 - c.qw <= -91) ? c.cneg : ((k0 - c.qw - 31 >= 91) ? c.cpos : 0.f); }
    else return 0.f;
}
template <int MODE> __device__ __forceinline__ void tile_fixup(f32x16& p0, f32x16& p1, const TCtx<MODE>& c, int kt) {
    if constexpr (MODE == 0) {
        const int k0 = kt * KVBLK;
        const bool far = (k0 + 63 - c.qw <= -91) || (k0 - c.qw - 31 >= 91);
        if (!far) {
            const ATT_LAS float* tp = (const ATT_LAS float*)(uintptr_t)(unsigned)(c.tb + 4 * k0);
#pragma unroll
            for (int g = 0; g < 4; ++g) {
#pragma unroll
                for (int i = 0; i < 4; ++i) { const int r = 4 * g + i; p0[r] += tp[krow(r)]; p1[r] += tp[32 + krow(r)]; }
                SBAR();
            }
        }
    } else {
        const float NEG = -INFINITY;
        const bool ok = (kt >= c.rs_w) && (kt < c.rs_w + 8);
        if (ok) {
            const int dr = kt - c.r_w + 7;
            const ATT_LAS float* tp = (const ATT_LAS float*)(uintptr_t)(unsigned)(c.tb + dr * (NAT_ROW * 4));
#pragma unroll
            for (int g = 0; g < 4; ++g) {
#pragma unroll
                for (int i = 0; i < 4; ++i) { const int r = 4 * g + i;
                    const float x0 = p0[r] + tp[krow(r)], x1 = p1[r] + tp[32 + krow(r)];
                    p0[r] = ((unsigned)(krow(r) + c.a) < 16u) ? x0 : NEG;
                    p1[r] = ((unsigned)(krow(r) + 32 + c.a) < 16u) ? x1 : NEG; }
                SBAR();
            }
        } else {
#pragma unroll
            for (int r = 0; r < 16; ++r) { p0[r] = NEG; p1[r] = NEG; }
        }
    }
}

template <int MODE> __device__ __forceinline__ void partialSM(f32x16& p0, f32x16& p1, float& m_reg, float& mn, float& alpha, const TCtx<MODE>& c, int kt) {
    const float cadd = tile_cinit<MODE>(c, kt);
    tile_fixup<MODE>(p0, p1, c, kt);
    float pmax = p0[0];
#pragma unroll
    for (int r = 1; r < 16; ++r) pmax = fmaxf(pmax, p0[r]);
#pragma unroll
    for (int r = 0; r < 16; ++r) pmax = fmaxf(pmax, p1[r]);
    { auto rr = __builtin_amdgcn_permlane32_swap(__float_as_uint(pmax), __float_as_uint(pmax), false, false);
      pmax = fmaxf(__uint_as_float(rr[0]), __uint_as_float(rr[1])) + cadd; }
    if (__builtin_expect(__all(pmax - m_reg <= THR_L2), 1)) { mn = m_reg; alpha = 1.f; }
    else { mn = fmaxf(m_reg, pmax); alpha = __builtin_amdgcn_exp2f(m_reg - mn); m_reg = mn; }
    const float sub = mn - cadd;
#pragma unroll
    for (int r = 0; r < 16; ++r) p0[r] = p0[r] - sub;
#pragma unroll
    for (int r = 0; r < 16; ++r) p1[r] = p1[r] - sub;
#pragma unroll
    for (int r = 0; r < 16; ++r) p0[r] = __builtin_amdgcn_exp2f(p0[r]);
}
__device__ __forceinline__ void finishSM(f32x16& p0, f32x16& p1, float alpha, float& l_reg, bf16x8& pa0, bf16x8& pa1, bf16x8& pa2, bf16x8& pa3) {
#pragma unroll
    for (int r = 0; r < 16; ++r) p1[r] = __builtin_amdgcn_exp2f(p1[r]);
    float ps = 0;
#pragma unroll
    for (int r = 0; r < 16; ++r) ps += p0[r];
#pragma unroll
    for (int r = 0; r < 16; ++r) ps += p1[r];
    { auto rr = __builtin_amdgcn_permlane32_swap(__float_as_uint(ps), __float_as_uint(ps), false, false);
      ps = __uint_as_float(rr[0]) + __uint_as_float(rr[1]); }
    l_reg = l_reg * alpha + ps;
#define PK4(P, BASE, OUT) do { unsigned a0 = cvtpk(P[BASE + 0], P[BASE + 1]), a1 = cvtpk(P[BASE + 2], P[BASE + 3]);   \
    unsigned b0 = cvtpk(P[BASE + 4], P[BASE + 5]), b1 = cvtpk(P[BASE + 6], P[BASE + 7]);                              \
    auto r0 = __builtin_amdgcn_permlane32_swap(a0, b0, false, false); auto r1 = __builtin_amdgcn_permlane32_swap(a1, b1, false, false); \
    u32x4 w = {r0[0], r1[0], r0[1], r1[1]}; OUT = *reinterpret_cast<bf16x8*>(&w); } while (0)
    PK4(p0, 0, pa0); PK4(p0, 8, pa1); PK4(p1, 0, pa2); PK4(p1, 8, pa3);
#undef PK4
}
__device__ __forceinline__ void qkt(f32x16& p0, f32x16& p1, const char* Ks, const bf16x8* qr, int r32, int hi) {
    p0 = f32x16{}; p1 = f32x16{};
#pragma unroll
    for (int d0 = 0; d0 < 8; ++d0) { const int cb = (d0 * 16 + hi * 8) * 2;
        const bf16x8 b0 = *reinterpret_cast<const bf16x8*>(Ks + KSWZ(r32, cb));
        const bf16x8 b1 = *reinterpret_cast<const bf16x8*>(Ks + KSWZ(32 + r32, cb));
        p0 = __builtin_amdgcn_mfma_f32_32x32x16_bf16(b0, qr[d0], p0, 0, 0, 0);
        p1 = __builtin_amdgcn_mfma_f32_32x32x16_bf16(b1, qr[d0], p1, 0, 0, 0); }
}
__device__ __forceinline__ int v_st(int k, int c) { const int kk = (k & ~0xC) | ((k & 4) << 1) | ((k & 8) >> 1); return ((kk >> 3) * 4 + (c >> 5)) * 512 + ((kk & 7) * 32 + (c & 31)) * 2; }
__device__ __forceinline__ int v_rd_base(int lane) { return ((lane & 3) << 3) | (((lane >> 2) & 3) << 6) | (((lane >> 4) & 1) << 5) | (((lane >> 5) & 1) << 8); }
constexpr int v_rd_off(int d0, int ks, int half) { return d0 * 512 + ks * 4096 + half * 2048; }
template <int OFF> __device__ __forceinline__ s16x4 tr_read(int vb) {
    s16x4 r; asm volatile("ds_read_b64_tr_b16 %0, %1 offset:%2" : "=&v"(r) : "v"(vb), "i"(OFF) : "memory"); return r;
}
template <int D0> __device__ __forceinline__ void pv_one(f32x16& od, int vb, bf16x8 pa0, bf16x8 pa1, bf16x8 pa2, bf16x8 pa3) {
    const s16x4 l0 = tr_read<v_rd_off(D0, 0, 0)>(vb), h0 = tr_read<v_rd_off(D0, 0, 1)>(vb), l1 = tr_read<v_rd_off(D0, 1, 0)>(vb), h1 = tr_read<v_rd_off(D0, 1, 1)>(vb);
    const s16x4 l2 = tr_read<v_rd_off(D0, 2, 0)>(vb), h2 = tr_read<v_rd_off(D0, 2, 1)>(vb), l3 = tr_read<v_rd_off(D0, 3, 0)>(vb), h3 = tr_read<v_rd_off(D0, 3, 1)>(vb);
    asm volatile("s_waitcnt lgkmcnt(0)" ::: "memory"); SBAR();
#define PK(L, H) (bf16x8){L[0], L[1], L[2], L[3], H[0], H[1], H[2], H[3]}
    od = __builtin_amdgcn_mfma_f32_32x32x16_bf16(pa0, PK(l0, h0), od, 0, 0, 0);
    od = __builtin_amdgcn_mfma_f32_32x32x16_bf16(pa1, PK(l1, h1), od, 0, 0, 0);
    od = __builtin_amdgcn_mfma_f32_32x32x16_bf16(pa2, PK(l2, h2), od, 0, 0, 0);
    od = __builtin_amdgcn_mfma_f32_32x32x16_bf16(pa3, PK(l3, h3), od, 0, 0, 0);
#undef PK
}
__device__ __forceinline__ void pv_d0(f32x16* o, int vb, bf16x8 pa0, bf16x8 pa1, bf16x8 pa2, bf16x8 pa3) {
    pv_one<0>(o[0], vb, pa0, pa1, pa2, pa3); pv_one<1>(o[1], vb, pa0, pa1, pa2, pa3); pv_one<2>(o[2], vb, pa0, pa1, pa2, pa3); pv_one<3>(o[3], vb, pa0, pa1, pa2, pa3);
}

template <int MODE>
__device__ __forceinline__ void attn_unit(int epi, const bf16_t* __restrict__ Qb, const bf16_t* __restrict__ Kh, const bf16_t* __restrict__ Vh, int kt0, int NT, int ktmax,
                                          const TCtx<MODE>& ctx, float* Of, bf16_t* Ob, int ldo, float lam, char* lds) {
    int tid = threadIdx.x; asm volatile("" : "+v"(tid));
    const int wid = tid >> 6, lane = tid & 63, r32 = lane & 31, hi = lane >> 5;
    char* V_lds = lds + OFF_V; char* K_lds = lds + OFF_K;
    float* ws = (float*)(lds + OFF_WS) + wid * 64; float* li_l = ws; float* al_l = ws + 32;
    float m_reg = -1e30f, l_reg = 0; f32x16 o[4] = {}; bf16x8 qr[8];
    const bf16_t* Qw = Qb + (long)(wid * QBLK + r32) * LDP + hi * 8;
#pragma unroll
    for (int d0 = 0; d0 < 8; ++d0) qr[d0] = *reinterpret_cast<const bf16x8*>(Qw + d0 * 16);
    const int sr = tid >> 4, sc = (tid & 15) * 8, vst0 = v_st(sr, sc), vst1 = v_st(32 + sr, sc);
    const int vb0 = (int)(uintptr_t)V_lds + v_rd_base(lane);
    struct { bf16x8 vs0, vs1, ks0, ks1; } sr_[SDEPTH];
#define TROW(t) ((long)((((kt0 + (t)) < ktmax ? (kt0 + (t)) : ktmax)) * KVBLK))
#define SLOAD(i, t) do { const long k0_ = TROW(t); sr_[i].vs0 = *reinterpret_cast<const bf16x8*>(&Vh[(k0_ + sr) * LDP + sc]); sr_[i].vs1 = *reinterpret_cast<const bf16x8*>(&Vh[(k0_ + 32 + sr) * LDP + sc]); \
    sr_[i].ks0 = *reinterpret_cast<const bf16x8*>(&Kh[(k0_ + sr) * LDP + sc]); sr_[i].ks1 = *reinterpret_cast<const bf16x8*>(&Kh[(k0_ + 32 + sr) * LDP + sc]); } while (0)
#define SWRITE(b, i) do { *(bf16x8*)(V_lds + (b) * SHM_V + vst0) = sr_[i].vs0;          \
    *(bf16x8*)(V_lds + (b) * SHM_V + vst1) = sr_[i].vs1; const int kc = sc * 2;               \
    *(bf16x8*)(K_lds + (b) * SHM_K + KSWZ(sr, kc)) = sr_[i].ks0;                       \
    *(bf16x8*)(K_lds + (b) * SHM_K + KSWZ(32 + sr, kc)) = sr_[i].ks1; } while (0)
#define SWAIT() do { if constexpr (SDEPTH == 2) asm volatile("s_waitcnt vmcnt(4)" ::: "memory"); else asm volatile("s_waitcnt vmcnt(0)" ::: "memory"); } while (0)
#define RESC(a) do { if (__any((a) < 1.f)) { if (hi == 0) al_l[r32] = (a); asm volatile("s_waitcnt lgkmcnt(0)" ::: "memory"); \
    _Pragma("unroll") for (int d = 0; d < 4; ++d) _Pragma("unroll") for (int r = 0; r < 16; ++r) o[d][r] *= al_l[crow(r, hi)]; } } while (0)
    f32x16 pA0, pA1, pB0, pB1; float mnA, mnB, alA, alB; bf16x8 pa0, pa1, pa2, pa3;
    constexpr int SE = 0, SO = SDEPTH - 1;
    SLOAD(SE, 0); asm volatile("s_waitcnt vmcnt(0)" ::: "memory"); SWRITE(0, SE); __syncthreads();
    qkt(pA0, pA1, K_lds, qr, r32, hi); partialSM<MODE>(pA0, pA1, m_reg, mnA, alA, ctx, kt0);
    SLOAD(SO, 1); if constexpr (SDEPTH == 2) { if (2 < NT) SLOAD(SE, 2); }
    SWAIT(); SWRITE(1, SO); __syncthreads();
    for (int j = 1; j + 1 < NT; j += 2) {
        SBAR(); qkt(pB0, pB1, K_lds + SHM_K, qr, r32, hi);
        finishSM(pA0, pA1, alA, l_reg, pa0, pa1, pa2, pa3); SBAR();
        SLOAD(SO, j + SDEPTH); SBAR();
        pv_d0(o, vb0, pa0, pa1, pa2, pa3); partialSM<MODE>(pB0, pB1, m_reg, mnB, alB, ctx, kt0 + j);
        __syncthreads(); SWAIT(); SWRITE(0, SE);
        RESC(alB); __syncthreads();
        SBAR(); qkt(pA0, pA1, K_lds, qr, r32, hi);
        finishSM(pB0, pB1, alB, l_reg, pa0, pa1, pa2, pa3); SBAR();
        if (SDEPTH == 1 || j + 3 < NT) SLOAD(SE, j + 1 + SDEPTH); SBAR();
        pv_d0(o, vb0 + SHM_V, pa0, pa1, pa2, pa3); partialSM<MODE>(pA0, pA1, m_reg, mnA, alA, ctx, kt0 + j + 1);
        __syncthreads(); SWAIT(); SWRITE(1, SO);
        RESC(alA); __syncthreads();
    }
    SBAR(); qkt(pB0, pB1, K_lds + SHM_K, qr, r32, hi);
    finishSM(pA0, pA1, alA, l_reg, pa0, pa1, pa2, pa3); SBAR();
    pv_d0(o, vb0, pa0, pa1, pa2, pa3); partialSM<MODE>(pB0, pB1, m_reg, mnB, alB, ctx, kt0 + NT - 1);
    __syncthreads(); RESC(alB);
    finishSM(pB0, pB1, alB, l_reg, pa0, pa1, pa2, pa3); SBAR();
    pv_d0(o, vb0 + SHM_V, pa0, pa1, pa2, pa3);
    if (hi == 0) li_l[r32] = l_reg; asm volatile("s_waitcnt lgkmcnt(0)" ::: "memory");
    float rli[16];
#pragma unroll
    for (int r = 0; r < 16; ++r) rli[r] = __builtin_amdgcn_rcpf(li_l[crow(r, hi)]);
#define OLOOP(BODY) _Pragma("unroll") for (int r = 0; r < 16; ++r) { const long orow = wid * QBLK + crow(r, hi); \
        _Pragma("unroll") for (int d0 = 0; d0 < 4; ++d0) { const float v = o[d0][r] * rli[r]; const long off = orow * ldo + d0 * 32 + r32; BODY } }
    if constexpr (MODE == 1) { OLOOP(Ob[off] = (bf16_t)(cvtpk(v, 0.f) & 0xffffu);) }
    else { if (epi == 0) { OLOOP(Of[off] = v;) }
           else { OLOOP(const float prev = __hip_atomic_load(Of + off, __ATOMIC_RELAXED, __HIP_MEMORY_SCOPE_AGENT); Of[off] = prev - lam * v;) } }
#undef OLOOP
    __syncthreads();
#undef TROW
#undef SLOAD
#undef SWRITE
#undef SWAIT
#undef RESC
}
#undef SBAR
}

constexpr int NWAVES = 8;
constexpr size_t MiB = 1u << 20;
constexpr size_t WS_CTL = 0, CTL_ZERO_BYTES = 1 * MiB;
constexpr size_t WS_WIN = 2 * MiB;
constexpr size_t WS_WD = WS_WIN;
constexpr size_t WS_WO = 26 * MiB;
constexpr size_t WS_WGU = 34 * MiB;
constexpr size_t WS_HB = 78 * MiB;
constexpr size_t WS_PROJ = 110 * MiB;
constexpr size_t WS_MIX = 206 * MiB;
constexpr size_t WS_END = 238 * MiB;
constexpr int CW_BAR = 4096;
constexpr int RING_BYTES = 131072, LDSCTL_OFF = RING_BYTES, MISC_OFF = LDSCTL_OFF + 320, LDS_BYTES = 147456;
static_assert(att::LDS_END <= RING_BYTES, "attention LDS");

#define GAS __attribute__((address_space(1)))
#define LAS __attribute__((address_space(3)))
typedef unsigned short bf16_t;
typedef unsigned v4u __attribute__((ext_vector_type(4)));
typedef unsigned v2u __attribute__((ext_vector_type(2)));
typedef float f32x4 __attribute__((ext_vector_type(4)));
#define LDS_WAIT() asm volatile("s_waitcnt lgkmcnt(0)" ::: "memory")
#define VM_WAIT() asm volatile("s_waitcnt vmcnt(0)" ::: "memory")
__device__ __forceinline__ unsigned f2bf(float f) { unsigned u = __builtin_bit_cast(unsigned, f); return (u + 0x7fffu + ((u >> 16) & 1u)) >> 16; }
__device__ __forceinline__ unsigned pk2(float lo, float hi) { return f2bf(lo) | (f2bf(hi) << 16); }
__device__ __forceinline__ float bf2f(bf16_t b) { return __builtin_bit_cast(float, (unsigned)b << 16); }
#define XB_TMO      128
#define XB_XCNT(j)  (256  + 64 * (j))
#define XB_XSUB(j)  (1280 + 64 * (j))
#define XB_XGEN(j)  (2304 + 64 * (j))
#define XB_TOP      3328
#define XB_TOPGEN   3392
#define XCD_BAR_WORDS 3456
#define XB_SPIN_CAP (1u << 18)

__device__ __forceinline__ unsigned xb_ld(unsigned* p)              { return __hip_atomic_load(p, __ATOMIC_RELAXED, __HIP_MEMORY_SCOPE_AGENT); }
__device__ __forceinline__ unsigned xb_add(unsigned* p, unsigned v) { return __hip_atomic_fetch_add(p, v, __ATOMIC_RELAXED, __HIP_MEMORY_SCOPE_AGENT); }
__device__ __forceinline__ unsigned xb_xcc_id() { return (unsigned)__builtin_amdgcn_s_getreg((3 << 11) | 20) & 0xFu; }
#define XB_SPIN(cond, bar) do { unsigned _sp = 0; while (cond) { __builtin_amdgcn_s_sleep(1); \
    if ((++_sp & 255u) == 0u) { if (xb_ld(&(bar)[XB_TMO])) break; if (_sp > XB_SPIN_CAP) { atomicAdd(&(bar)[XB_TMO], 1u); break; } } } } while (0)

struct XcdBarrier {
    unsigned* bar; unsigned x;
    volatile LAS unsigned* st;
};

__device__ __forceinline__ XcdBarrier xcd_barrier_post(unsigned* bar, volatile LAS unsigned* st) {
    XcdBarrier b; b.bar = bar; b.x = xb_xcc_id(); b.st = st;
    if (threadIdx.x == 0) (void)xb_add(&bar[XB_XCNT(b.x)], 1u);
    return b;
}
__device__ __forceinline__ void xcd_barrier_complete(unsigned* bar, unsigned x, unsigned& nloc, unsigned& nx) {
    const unsigned G = gridDim.x * gridDim.y * gridDim.z;
    unsigned sum, cnt, mine, sp = 0u;
    for (;;) {
        sum = 0u; cnt = 0u; mine = 0u;
#pragma unroll
        for (unsigned j = 0; j < 16; ++j) { const unsigned c = xb_ld(&bar[XB_XCNT(j)]); sum += c; cnt += (c > 0u) ? 1u : 0u; mine = (j == x) ? c : mine; }
        if (sum == G) break;
        __builtin_amdgcn_s_sleep(1);
        if ((++sp & 255u) == 0u) { if (xb_ld(&bar[XB_TMO])) break; if (sp > XB_SPIN_CAP) { atomicAdd(&bar[XB_TMO], 1u); break; } }
    }
    nloc = mine > 0u ? mine : 1u; nx = cnt > 0u ? cnt : 1u;
}

__device__ __forceinline__ void xcd_barrier(const XcdBarrier& b) {
    asm volatile("s_waitcnt vmcnt(0)" ::: "memory");
    __syncthreads();
    if (threadIdx.x == 0) {
        unsigned* bar = b.bar;
        __builtin_amdgcn_s_waitcnt(0);
        unsigned nloc = b.st[0], nx = b.st[1];
        if (nloc == 0u) { xcd_barrier_complete(bar, b.x, nloc, nx); b.st[0] = nloc; b.st[1] = nx; }
        const unsigned old = xb_add(&bar[XB_XSUB(b.x)], 1u);
        const unsigned gen = old / nloc;
        if (old + 1u == (gen + 1u) * nloc) {
            __builtin_amdgcn_fence(__ATOMIC_RELEASE, "agent");
            asm volatile("s_waitcnt vmcnt(0)" ::: "memory");
            const unsigned og = xb_add(&bar[XB_TOP], 1u);
            const unsigned tg = og / nx;
            if (og + 1u == (tg + 1u) * nx) xb_add(&bar[XB_TOPGEN], 1u);
            else XB_SPIN(xb_ld(&bar[XB_TOPGEN]) == tg, bar);
            __builtin_amdgcn_fence(__ATOMIC_ACQUIRE, "agent");
            xb_add(&bar[XB_XGEN(b.x)], 1u);
            asm volatile("s_waitcnt vmcnt(0)" ::: "memory");
        } else {
            XB_SPIN(xb_ld(&bar[XB_XGEN(b.x)]) == gen, bar);
            __builtin_amdgcn_fence(__ATOMIC_ACQUIRE, "agent");
            asm volatile("s_waitcnt vmcnt(0)" ::: "memory");
        }
    }
    __syncthreads();
}

struct Args { const float* in[19]; float* out; unsigned char* ws; int ph_lo, ph_hi; };

struct Frame {
    LAS unsigned char* lds; int tid, lane, wave, vcu, G;
};
__device__ __forceinline__ float wave_sum(float v) {
#pragma unroll
    for (int o = 1; o < 64; o <<= 1) v += __shfl_xor(v, o);
    return v;
}
__device__ __forceinline__ void transpose_item(const float* __restrict__ W, int N, bf16_t* WT, int KT, int k0, int n0, int drow0, LAS float* scr, int lane) {
#pragma unroll 8
    for (int i = 0; i < 32; ++i) { const int kk = 2 * i + (lane >> 5); scr[kk * 33 + (lane & 31)] = W[(size_t)(k0 + kk) * N + n0 + (lane & 31)]; }
    LDS_WAIT(); asm volatile("" ::: "memory");
    const int c = lane & 7;
#pragma unroll
    for (int j = 0; j < 4; ++j) { const int n = (lane >> 3) + 8 * j; const LAS float* s = scr + (8 * c) * 33 + n;
        v4u o; o.x = pk2(s[0 * 33], s[1 * 33]); o.y = pk2(s[2 * 33], s[3 * 33]); o.z = pk2(s[4 * 33], s[5 * 33]); o.w = pk2(s[6 * 33], s[7 * 33]);
        *(GAS v4u*)(WT + (size_t)(drow0 + n) * KT + k0 + 8 * c) = o; }
    LDS_WAIT(); asm volatile("" ::: "memory");
}
template <bool WF32, bool WBF16>
__device__ __forceinline__ void ln_row(const float* xrow, const float* __restrict__ g, const float* __restrict__ b, float* orow, bf16_t* brow, int lane) {
    const GAS f32x4* xr = (const GAS f32x4*)xrow + lane;
    f32x4 v[8]; float s = 0.f;
#pragma unroll
    for (int j = 0; j < 8; ++j) { v[j] = xr[64 * j]; s += (v[j].x + v[j].y) + (v[j].z + v[j].w); }
    const float mean = wave_sum(s) * (1.f / DM); float s2 = 0.f;
#pragma unroll
    for (int j = 0; j < 8; ++j) { v[j] = v[j] - mean; s2 += (v[j].x * v[j].x + v[j].y * v[j].y) + (v[j].z * v[j].z + v[j].w * v[j].w); }
    const float rstd = 1.f / sqrtf(wave_sum(s2) * (1.f / DM) + LN_EPS);
    const GAS f32x4* gr = (const GAS f32x4*)g + lane; const GAS f32x4* br = (const GAS f32x4*)b + lane;
#pragma unroll
    for (int j = 0; j < 8; ++j) { const f32x4 y = v[j] * rstd * gr[64 * j] + br[64 * j];
        if (WF32) ((GAS f32x4*)orow + lane)[64 * j] = y;
        if (WBF16) { v2u w; w.x = pk2(y.x, y.y); w.y = pk2(y.z, y.w); ((GAS v2u*)brow + lane)[64 * j] = w; } }
}

__global__ void __launch_bounds__(NWAVES * 64, 2) fwd_mega(Args args) {
    extern __shared__ __attribute__((aligned(16))) unsigned char lds[];
    Frame F; F.lds = (LAS unsigned char*)lds;
    volatile LAS unsigned* MISC = (volatile LAS unsigned*)(F.lds + MISC_OFF);
    F.tid = threadIdx.x; F.lane = F.tid & 63; F.wave = __builtin_amdgcn_readfirstlane(F.tid >> 6);
    F.G = gridDim.x; { const int bx = blockIdx.x; F.vcu = (F.G % 8 == 0) ? (bx % 8) * (F.G / 8) + bx / 8 : bx; }
    unsigned char* ws = args.ws;
    unsigned* ctl = (unsigned*)(ws + WS_CTL);
    const float* x = args.in[0]; const float* ln_in_g = args.in[1]; const float* ln_in_b = args.in[2]; const float* w_in = args.in[3]; const float* na_rpb = args.in[4];
    const float* lq1 = args.in[5]; const float* lk1 = args.in[6]; const float* lq2 = args.in[7]; const float* lk2 = args.in[8]; const float* subg = args.in[9];
    const float* relt = args.in[10]; const float* w_out = args.in[11]; const float* ln1_g = args.in[12]; const float* ln1_b = args.in[13];
    const float* w_gate = args.in[14]; const float* w_up = args.in[15]; const float* w_down = args.in[16]; const float* ln2_g = args.in[17]; const float* ln2_b = args.in[18];
    float* out = args.out;
    bf16_t* Win_t = (bf16_t*)(ws + WS_WIN); bf16_t* Wd_t = (bf16_t*)(ws + WS_WD); bf16_t* Wo_t = (bf16_t*)(ws + WS_WO); bf16_t* Wgu_t = (bf16_t*)(ws + WS_WGU);
    bf16_t* HB = (bf16_t*)(ws + WS_HB); float* STASH = (float*)(ws + WS_HB); bf16_t* PROJ = (bf16_t*)(ws + WS_PROJ); bf16_t* HMID = (bf16_t*)(ws + WS_PROJ); bf16_t* MIX = (bf16_t*)(ws + WS_MIX);
    for (int u = F.tid; u < (LDS_BYTES - LDSCTL_OFF) / 4; u += NWAVES * 64) ((LAS unsigned*)(F.lds + LDSCTL_OFF))[u] = 0u;
    __syncthreads();
    XcdBarrier bar = xcd_barrier_post(ctl + CW_BAR, MISC + 8);
    const int lo = args.ph_lo, hi = args.ph_hi;
#ifndef PHMASK
#define PHMASK 0x1ff
#endif
#define IN(k) (((PHMASK >> (k)) & 1) && lo <= (k) && (k) < hi)
#define BOTH(k) (IN(k) && IN((k) + 1))
    const int gw = F.vcu * NWAVES + F.wave, NGW = F.G * NWAVES;

    if (IN(0)) {
        LAS float* scr = (LAS float*)(F.lds + F.wave * 16384);
        constexpr int I_IN = (DM / 64) * (INW / 32), I_O = (DM / 64) * (DM / 32), I_G = (DM / 64) * (DFF / 32);
        constexpr int NITEMS = I_IN + I_O + 2 * I_G;
        for (int it = gw; it < NITEMS; it += NGW) {
            int r = it;
            if (r < I_IN) { const int nb = r % (INW / 32), kb = r / (INW / 32); transpose_item(w_in, INW, Win_t, DM, 64 * kb, 32 * nb, 32 * nb, scr, F.lane); continue; } r -= I_IN;
            if (r < I_O) { const int nb = r % (DM / 32), kb = r / (DM / 32); transpose_item(w_out, DM, Wo_t, DM, 64 * kb, 32 * nb, 32 * nb, scr, F.lane); continue; } r -= I_O;
            const bool up = r >= I_G; if (up) r -= I_G;
            { const int nb = r % (DFF / 32), kb = r / (DFF / 32), n0 = 32 * nb; transpose_item(up ? w_up : w_gate, DFF, Wgu_t, DM, 64 * kb, n0, 256 * (n0 >> 7) + (up ? 128 : 0) + (n0 & 127), scr, F.lane); }
        }
        for (int m = gw; m < M; m += NGW) ln_row<true, true>(x + (size_t)m * DM, ln_in_g, ln_in_b, out + (size_t)m * DM, HB + (size_t)m * DM, F.lane);
        if (BOTH(0)) xcd_barrier(bar);
    }
    if (IN(1)) {
        pg8::Gemm g{HB, Win_t, M, INW, DM}; pg8::StaticOrder S; S.init(M, INW, F.G, (int)blockIdx.x);
        pg8::EpiProj E{PROJ, INW};
        pg8::gemm_phase<pg8::EpiProj, pg8::StaticOrder, true, true>(F.lds, g, S, E);
        if (BOTH(1)) xcd_barrier(bar);
    }
    if (IN(2)) {
        char* alds = (char*)lds;
        const int r32 = F.lane & 31, hi5 = F.lane >> 5;
        float lam;
        { const float a = lq1[F.lane] * lk1[F.lane] + lq1[F.lane + 64] * lk1[F.lane + 64], b2 = lq2[F.lane] * lk2[F.lane] + lq2[F.lane + 64] * lk2[F.lane + 64];
          lam = __expf(wave_sum(a)) - __expf(wave_sum(b2)) + LAMBDA_INIT; }
        for (int du = F.vcu; du < 256; du += F.G) {
            const int bh = du >> 5, b = bh >> 2, h = bh & 3, half = (du >> 4) & 1, qb = du & 15;
            for (int i = F.tid; i < att::T5N; i += NWAVES * 64) ((LAS float*)(F.lds + att::OFF_T5))[i] = relt[att::t5_bucket(i - 192) * DH + h] * LOG2E;
            const size_t tok0 = (size_t)b * SEQ; const int q0 = qb * 256;
            att::TCtx<0> c; c.qw = q0 + F.wave * 32; c.tb = (int)(uintptr_t)(alds + att::OFF_T5) + 4 * (4 * hi5 - r32 + 192 - c.qw);
            c.cneg = relt[15 * DH + h] * LOG2E; c.cpos = relt[31 * DH + h] * LOG2E; c.r_w = 0; c.rs_w = 0; c.a = 0;
            const bf16_t* Pb = PROJ + tok0 * INW;
            float* Of = STASH + ((tok0 + q0) * DH + h) * DV + half * 128;
            const bf16_t* Vh = Pb + 5 * NAW + h * DV + half * 128;
#pragma nounroll
            for (int mp = 0; mp < 2; ++mp)
                att::attn_unit<0>(mp, Pb + (size_t)q0 * INW + 3 * NAW + h * 256 + mp * 128, Pb + 4 * NAW + h * 256 + mp * 128, Vh, 0, SEQ / 64, SEQ / 64 - 1, c, Of, nullptr, DH * DV, lam, alds);
        }
        for (int nu = F.vcu; nu < 256; nu += F.G) {
            const int bh = nu >> 4, b = bh >> 3, h = bh & 7, rg = nu & 15, r0 = 4 * rg;
            for (int i = F.tid; i < 15 * att::NAT_ROW; i += NWAVES * 64) { const int dr = i >> 7, xx = (i & 127) - 48;
                ((LAS float*)(F.lds + att::OFF_NAT))[i] = (xx >= 0 && xx < 31) ? na_rpb[(h * 15 + dr) * 31 + xx] * LOG2E : 0.f; }
            const size_t tok0 = (size_t)b * SEQ; const int q0 = r0 * GW;
            att::TCtx<1> c; c.qw = q0 + F.wave * 32; c.r_w = c.qw >> 6; c.rs_w = min(max(c.r_w - 4, 0), 56);
            const int qc = (c.qw & 63) + r32, cs = min(max(qc - 8, 0), 48);
            c.a = 4 * hi5 - cs; c.tb = (int)(uintptr_t)(alds + att::OFF_NAT) + 4 * (4 * hi5 - qc + 63); c.cneg = 0.f; c.cpos = 0.f;
            const int ktb = min(max(r0 - 4, 0), 56), kte = min(max(r0 - 1, 0), 56) + 8, NT = (kte - ktb + 1) & ~1;
            const bf16_t* Pb = PROJ + tok0 * INW;
            att::attn_unit<1>(2, Pb + (size_t)q0 * INW + h * HD, Pb + NAW + h * HD, Pb + 2 * NAW + h * HD, ktb, NT, 63, c, nullptr, MIX + (tok0 + q0) * DM + h * HD, DM, 0.f, alds);
        }
        if (BOTH(2)) xcd_barrier(bar);
    }
    if (IN(3)) {
        for (int rw = gw; rw < M * DH; rw += NGW) {
            const f32x4 v = ((const GAS f32x4*)(STASH + (size_t)rw * DV))[F.lane];
            const float ss = wave_sum((v.x * v.x + v.y * v.y) + (v.z * v.z + v.w * v.w));
            const float rs = (1.f / sqrtf(ss * (1.f / DV) + LN_EPS)) * (1.f - LAMBDA_INIT);
            const f32x4 gg = ((const GAS f32x4*)subg)[F.lane];
            v2u w; w.x = pk2(v.x * rs * gg.x, v.y * rs * gg.y); w.y = pk2(v.z * rs * gg.z, v.w * rs * gg.w);
            ((GAS v2u*)(MIX + (size_t)(rw >> 2) * DM + NAW + (rw & 3) * DV))[F.lane] = w;
        }
        LAS float* scr = (LAS float*)(F.lds + F.wave * 16384);
        constexpr int I_D = (DFF / 64) * (DM / 32);
        for (int it = gw; it < I_D; it += NGW) { const int nb = it % (DM / 32), kb = it / (DM / 32); transpose_item(w_down, DM, Wd_t, DFF, 64 * kb, 32 * nb, 32 * nb, scr, F.lane); }
        if (BOTH(3)) xcd_barrier(bar);
    }
    if (IN(4)) {
        pg8::Gemm g{MIX, Wo_t, M, DM, DM}; pg8::StaticOrder S; S.init(M, DM, F.G, (int)blockIdx.x);
        pg8::EpiRes E{out, DM};
        pg8::gemm_phase<pg8::EpiRes, pg8::StaticOrder, true, true>(F.lds, g, S, E);
        if (BOTH(4)) xcd_barrier(bar);
    }
    if (IN(5)) {
        for (int m = gw; m < M; m += NGW) ln_row<true, true>(out + (size_t)m * DM, ln1_g, ln1_b, out + (size_t)m * DM, HB + (size_t)m * DM, F.lane);
        if (BOTH(5)) xcd_barrier(bar);
    }
    if (IN(6)) {
        pg8::Gemm g{HB, Wgu_t, M, NGU, DM}; pg8::StaticOrder S; S.init(M, NGU, F.G, (int)blockIdx.x);
        pg8::EpiSwiGLU E{HMID, DFF};
        pg8::gemm_phase<pg8::EpiSwiGLU, pg8::StaticOrder, true, true>(F.lds, g, S, E);
        if (BOTH(6)) xcd_barrier(bar);
    }
    if (IN(7)) {
        pg8::Gemm g{HMID, Wd_t, M, DM, DFF}; pg8::StaticOrder S; S.init(M, DM, F.G, (int)blockIdx.x);
        pg8::EpiRes E{out, DM};
        pg8::gemm_phase<pg8::EpiRes, pg8::StaticOrder, true, true>(F.lds, g, S, E);
        if (BOTH(7)) xcd_barrier(bar);
    }
    if (IN(8)) {
        for (int m = gw; m < M; m += NGW) ln_row<true, false>(out + (size_t)m * DM, ln2_g, ln2_b, out + (size_t)m * DM, nullptr, F.lane);
    }
#undef IN
#undef BOTH
}
constexpr int N_PHASES = 9;

#if HYB > 0
__device__ __forceinline__ float block_sum_256(float v, float* red) {
    for (int o = 32; o > 0; o >>= 1) v += __shfl_xor(v, o);
    __syncthreads();
    if ((threadIdx.x & 63) == 0) red[threadIdx.x >> 6] = v;
    __syncthreads();
    return red[0] + red[1] + red[2] + red[3];
}
__device__ __forceinline__ float block_max_256(float v, float* red) {
    for (int o = 32; o > 0; o >>= 1) v = fmaxf(v, __shfl_xor(v, o));
    __syncthreads();
    if ((threadIdx.x & 63) == 0) red[threadIdx.x >> 6] = v;
    __syncthreads();
    return fmaxf(fmaxf(red[0], red[1]), fmaxf(red[2], red[3]));
}
__global__ __launch_bounds__(256) void ln_rows(const float* in, const float* __restrict__ g, const float* __restrict__ b, float* out) {
    __shared__ float red[4];
    const size_t row = blockIdx.x; const int t = threadIdx.x;
    float v[8]; float s = 0.f;
    for (int i = 0; i < 8; ++i) { v[i] = in[row * DM + t + 256 * i]; s += v[i]; }
    const float mean = block_sum_256(s, red) * (1.f / DM);
    float q = 0.f;
    for (int i = 0; i < 8; ++i) { v[i] -= mean; q += v[i] * v[i]; }
    const float var = block_sum_256(q, red) * (1.f / DM);
    const float rstd = 1.0f / sqrtf(var + LN_EPS);
    for (int i = 0; i < 8; ++i) { const int c = t + 256 * i; out[row * DM + c] = v[i] * rstd * g[c] + b[c]; }
}
__device__ __forceinline__ float ldA(const float* p, size_t i) { return p[i]; }
__device__ __forceinline__ float ldA(const bf16_t* p, size_t i) { return bf2f(p[i]); }
__device__ __forceinline__ void stC(float* p, size_t i, float v) { p[i] = v; }
__device__ __forceinline__ void stC(bf16_t* p, size_t i, float v) { p[i] = (bf16_t)f2bf(v); }
template <int EPI, typename TA, typename TC>
__global__ __launch_bounds__(256) void gemm_naive(const TA* __restrict__ A, const float* __restrict__ B, const float* __restrict__ B2, const float* R, TC* C, int Mm, int N, int K) {
    __shared__ float As[8][128 + 4];
    __shared__ float Bs[8][128 + 4];
    __shared__ float Bs2[EPI == 2 ? 8 : 1][128 + 4];
    const int t = threadIdx.x, tx = t & 15, ty = t >> 4;
    const int row0 = blockIdx.y * 128, col0 = blockIdx.x * 128;
    float acc[8][8] = {}; float acc2[EPI == 2 ? 8 : 1][8] = {};
    for (int k0 = 0; k0 < K; k0 += 8) {
        { const int r = t >> 1, kk = (t & 1) * 4; for (int i = 0; i < 4; ++i) As[kk + i][r] = ldA(A, (size_t)(row0 + r) * K + k0 + kk + i); }
        { const int kk = t >> 5, c = (t & 31) * 4; const float4 b = *(const float4*)(B + (size_t)(k0 + kk) * N + col0 + c);
          *(float4*)&Bs[kk][c] = b;
          if (EPI == 2) { const float4 b2 = *(const float4*)(B2 + (size_t)(k0 + kk) * N + col0 + c); *(float4*)&Bs2[kk][c] = b2; } }
        __syncthreads();
#pragma unroll
        for (int kk = 0; kk < 8; ++kk) {
            float a[8], b[8];
            *(float4*)&a[0] = *(const float4*)&As[kk][ty * 8]; *(float4*)&a[4] = *(const float4*)&As[kk][ty * 8 + 4];
            *(float4*)&b[0] = *(const float4*)&Bs[kk][tx * 8]; *(float4*)&b[4] = *(const float4*)&Bs[kk][tx * 8 + 4];
#pragma unroll
            for (int i = 0; i < 8; ++i)
#pragma unroll
                for (int j = 0; j < 8; ++j) acc[i][j] = fmaf(a[i], b[j], acc[i][j]);
            if (EPI == 2) {
                float b2[8];
                *(float4*)&b2[0] = *(const float4*)&Bs2[kk][tx * 8]; *(float4*)&b2[4] = *(const float4*)&Bs2[kk][tx * 8 + 4];
#pragma unroll
                for (int i = 0; i < 8; ++i)
#pragma unroll
                    for (int j = 0; j < 8; ++j) acc2[i][j] = fmaf(a[i], b2[j], acc2[i][j]);
            }
        }
        __syncthreads();
    }
    for (int i = 0; i < 8; ++i)
        for (int j = 0; j < 8; ++j) {
            const size_t o = (size_t)(row0 + ty * 8 + i) * N + col0 + tx * 8 + j;
            float v = acc[i][j];
            if (EPI == 1) v = ALPHA * R[o] + v;
            if (EPI == 2) { const float gte = v; v = gte / (1.f + __expf(-gte)) * acc2[i][j]; }
            stC(C, o, v);
        }
}
__global__ __launch_bounds__(128) void na_naive(const bf16_t* __restrict__ P, const float* __restrict__ rpb, bf16_t* MIX) {
    __shared__ float qs[128]; __shared__ float ps[128]; __shared__ float red[2];
    const int tok = blockIdx.x, h = blockIdx.y, t = threadIdx.x;
    const int b = tok / SEQ, s = tok % SEQ, r = s / GW, c = s % GW;
    const int rs = min(max(r - 4, 0), 64 - 8), cs = min(max(c - 8, 0), GW - 16);
    qs[t] = bf2f(P[(size_t)tok * INW + h * HD + t]) * LN2;
    __syncthreads();
    const int i = t >> 4, j = t & 15;
    const int ktok = b * SEQ + (rs + i) * GW + cs + j;
    const bf16_t* kp = P + (size_t)ktok * INW + NAW + h * HD;
    float sc = 0.f;
    for (int d = 0; d < HD; ++d) sc = fmaf(qs[d], bf2f(kp[d]), sc);
    sc += rpb[(h * 15 + (rs + i - r + 7)) * 31 + (cs + j - c + 15)];
    float mx = sc;
    for (int o = 32; o > 0; o >>= 1) mx = fmaxf(mx, __shfl_xor(mx, o));
    if ((t & 63) == 0) red[t >> 6] = mx;
    __syncthreads();
    mx = fmaxf(red[0], red[1]);
    const float e = __expf(sc - mx);
    float sm = e;
    for (int o = 32; o > 0; o >>= 1) sm += __shfl_xor(sm, o);
    __syncthreads();
    if ((t & 63) == 0) red[t >> 6] = sm;
    __syncthreads();
    sm = red[0] + red[1];
    ps[t] = e / sm;
    __syncthreads();
    float o = 0.f;
    for (int k = 0; k < 128; ++k) {
        const int kt = b * SEQ + (rs + (k >> 4)) * GW + cs + (k & 15);
        o = fmaf(ps[k], bf2f(P[(size_t)kt * INW + 2 * NAW + h * HD + t]), o);
    }
    MIX[(size_t)tok * DM + h * HD + t] = (bf16_t)f2bf(o);
}
__global__ __launch_bounds__(256) void diff_naive(const bf16_t* __restrict__ P, const float* __restrict__ lq1, const float* __restrict__ lk1,
                                                  const float* __restrict__ lq2, const float* __restrict__ lk2, const float* __restrict__ subg,
                                                  const float* __restrict__ relt, bf16_t* MIX) {
    __shared__ float sc[2][SEQ]; __shared__ float qs[2][128]; __shared__ float red[4];
    const int tok = blockIdx.x, h = blockIdx.y, t = threadIdx.x, lane = t & 63, w = t >> 6;
    const int b = tok / SEQ, s = tok % SEQ;
    qs[t >> 7][t & 127] = bf2f(P[(size_t)tok * INW + 3 * NAW + h * 256 + t]) * LN2;
    float l1 = (t < 128) ? lq1[t] * lk1[t] : 0.f, l2 = (t < 128) ? lq2[t] * lk2[t] : 0.f;
    l1 = block_sum_256(l1, red); l2 = block_sum_256(l2, red);
    const float lam = __expf(l1) - __expf(l2) + LAMBDA_INIT;
    __syncthreads();
    for (int m = 0; m < 2; ++m) {
        const float q0 = qs[m][2 * lane], q1 = qs[m][2 * lane + 1];
        for (int k = w; k < SEQ; k += 4) {
            const unsigned kv = *(const unsigned*)(P + (size_t)(b * SEQ + k) * INW + 4 * NAW + h * 256 + m * 128 + 2 * lane);
            float d = q0 * bf2f((bf16_t)(kv & 0xffffu)) + q1 * bf2f((bf16_t)(kv >> 16));
            for (int o = 32; o > 0; o >>= 1) d += __shfl_xor(d, o);
            if (lane == 0) sc[m][k] = d + relt[att::t5_bucket(k - s) * DH + h];
        }
    }
    __syncthreads();
    float mx[2], sm[2];
    for (int m = 0; m < 2; ++m) {
        float a = -1e30f;
        for (int k = t; k < SEQ; k += 256) a = fmaxf(a, sc[m][k]);
        mx[m] = block_max_256(a, red);
        float z = 0.f;
        for (int k = t; k < SEQ; k += 256) { const float e = __expf(sc[m][k] - mx[m]); sc[m][k] = e; z += e; }
        sm[m] = block_sum_256(z, red);
    }
    __syncthreads();
    for (int k = t; k < SEQ; k += 256) sc[0][k] = sc[0][k] / sm[0] - lam * (sc[1][k] / sm[1]);
    __syncthreads();
    float o = 0.f;
    for (int k = 0; k < SEQ; ++k) o = fmaf(sc[0][k], bf2f(P[(size_t)(b * SEQ + k) * INW + 5 * NAW + h * 256 + t]), o);
    const float ms = block_sum_256(o * o, red) * (1.f / 256.f);
    MIX[(size_t)tok * DM + NAW + h * 256 + t] = (bf16_t)f2bf(o * (1.0f / sqrtf(ms + LN_EPS)) * subg[t] * (1.f - LAMBDA_INIT));
}
#endif

extern "C" void kernel_launch(void* const* d_in, const int* in_sizes, int n_in, void* d_out, int out_size, void* d_ws, size_t ws_size, hipStream_t stream) {
    static int grid = 0;
    if (grid == 0) {
        if (n_in != 19 || in_sizes[0] != M * DM || out_size != M * DM || ws_size < WS_END) { fprintf(stderr, "kernel_launch: unexpected shapes (n_in %d, in0 %d, out %d, ws %zu); nothing launched\n", n_in, n_in > 0 ? in_sizes[0] : -1, out_size, ws_size); grid = -1; return; }
        int dev = 0, cus = 0, per_cu = 0;
        if (hipGetDevice(&dev) != hipSuccess || hipDeviceGetAttribute(&cus, hipDeviceAttributeMultiprocessorCount, dev) != hipSuccess) { grid = -1; return; }
        if (hipFuncSetAttribute((const void*)fwd_mega, hipFuncAttributeMaxDynamicSharedMemorySize, LDS_BYTES) != hipSuccess) { fprintf(stderr, "kernel_launch: hipFuncSetAttribute failed\n"); grid = -1; return; }
        if (hipOccupancyMaxActiveBlocksPerMultiprocessor(&per_cu, (const void*)fwd_mega, NWAVES * 64, LDS_BYTES) != hipSuccess || per_cu < 1) { fprintf(stderr, "kernel_launch: occupancy query says %d blocks per CU\n", per_cu); }
        (void)hipGetLastError();
        grid = cus;
        if (grid > 256) grid = 256;
        if (grid % 8 != 0) grid = grid / 8 * 8;
    }
    if (grid < 0) return;
    hipMemsetAsync((char*)d_ws + WS_CTL, 0, CTL_ZERO_BYTES, stream);
    Args a{};
    for (int i = 0; i < 19; ++i) a.in[i] = (const float*)d_in[i];
    a.out = (float*)d_out; a.ws = (unsigned char*)d_ws;
#if HYB == 0
    a.ph_lo = 0; a.ph_hi = N_PHASES;
    hipLaunchKernelGGL(fwd_mega, dim3(grid), dim3(NWAVES * 64), LDS_BYTES, stream, a);
#else
    const int cutp = HYB == 1 ? 2 : HYB == 2 ? 4 : HYB == 3 ? 6 : 7;
    a.ph_lo = 0; a.ph_hi = cutp;
    hipLaunchKernelGGL(fwd_mega, dim3(grid), dim3(NWAVES * 64), LDS_BYTES, stream, a);
    const float* const* in = (const float* const*)d_in; float* out = (float*)d_out; unsigned char* ws = (unsigned char*)d_ws;
    bf16_t* PROJ = (bf16_t*)(ws + WS_PROJ); bf16_t* HMID = PROJ; bf16_t* MIX = (bf16_t*)(ws + WS_MIX);
    if (HYB <= 1) { na_naive<<<dim3(M, NAH), 128, 0, stream>>>(PROJ, in[4], MIX); diff_naive<<<dim3(M, DH), 256, 0, stream>>>(PROJ, in[5], in[6], in[7], in[8], in[9], in[10], MIX); }
    if (HYB <= 2) { gemm_naive<1, bf16_t, float><<<dim3(DM / 128, M / 128), 256, 0, stream>>>(MIX, in[11], nullptr, out, out, M, DM, DM); ln_rows<<<M, 256, 0, stream>>>(out, in[12], in[13], out); }
    if (HYB <= 3) gemm_naive<2, float, bf16_t><<<dim3(DFF / 128, M / 128), 256, 0, stream>>>(out, in[14], in[15], nullptr, HMID, M, DFF, DM);
    gemm_naive<1, bf16_t, float><<<dim3(DM / 128, M / 128), 256, 0, stream>>>(HMID, in[16], nullptr, out, out, M, DM, DFF);
    ln_rows<<<M, 256, 0, stream>>>(out, in[17], in[18], out);
#endif
    const hipError_t le = hipPeekAtLastError();
    if (le != hipSuccess) fprintf(stderr, "kernel_launch: launch failed: %s\n", hipGetErrorName(le));
}
```
